# Optimizing an MI355X kernel written in HIP

```python
import math
import jax, jax.numpy as jnp
from jax import lax
import numpy as np

D_MODEL = 1024
BATCH = 16
SEQ = 2048
DEPTH = 4

N_MIXERS = 4
GRID_W = 64
Q_BLOCK = 128
LN_EPS = 1e-5
RMS_EPS = 1e-6
DEEPNORM_ALPHA = (2 * DEPTH) ** 0.25
DEEPNORM_BETA = (8 * DEPTH) ** -0.25
D_FF = int(math.ceil(8 * D_MODEL / 3 / 256)) * 256
CONV_WIDTH = 3
DA_HEADS = 8
DA_HEAD_DIM = D_MODEL // (2 * DA_HEADS)
NA_HEADS = 16
NA_HEAD_DIM = D_MODEL // NA_HEADS
NA_MAX_ROWS = 8
NA_WIN_COLS = 16
MLA_HEADS = 16
MLA_Q_RANK = 256
MLA_KV_RANK = 128
MLA_NOPE = 64
MLA_ROPE = 32
MLA_V = 64
ROPE_THETA = 10000.0

kernel_name = "hybrid_interleaved_encoder_block"


def _n_uses(m):
    return len(range(m, DEPTH, N_MIXERS))


def _layer_norm(x, g, b):
    xf = x.astype(jnp.float32)
    mu = jnp.mean(xf, axis=-1, keepdims=True)
    var = jnp.mean(jnp.square(xf - mu), axis=-1, keepdims=True)
    y = (xf - mu) * lax.rsqrt(var + LN_EPS) * g.astype(jnp.float32) + b.astype(jnp.float32)
    return y.astype(x.dtype)


def _rms_norm(x, g):
    xf = x.astype(jnp.float32)
    y = xf * lax.rsqrt(jnp.mean(jnp.square(xf), axis=-1, keepdims=True) + RMS_EPS) * g.astype(jnp.float32)
    return y.astype(x.dtype)


def _to_blocks(t):
    b, s = t.shape[:2]
    return jnp.moveaxis(t.reshape((b, s // Q_BLOCK, Q_BLOCK) + t.shape[2:]), 1, 0)


def _from_blocks(t):
    t = jnp.moveaxis(t, 0, 1)
    return t.reshape((t.shape[0], t.shape[1] * t.shape[2]) + t.shape[3:])


def _alibi_slopes(n):
    return np.array([2.0 ** (-8.0 * (h + 1) / n) for h in range(n)], dtype=np.float32)


def _short_conv(x, w_in, conv_w, w_out):
    s = x.shape[1]
    bg, cg, h = jnp.split(x @ w_in, 3, axis=-1)
    u = jnp.pad(cg * h, ((0, 0), (1, 1), (0, 0)))
    y = conv_w[0] * u[:, 0:s] + conv_w[1] * u[:, 1:s + 1] + conv_w[2] * u[:, 2:s + 2]
    return (bg * y) @ w_out


def _diff_attention(x, w_qkv, lam, subln_g, w_out, layer_idx):
    b, s, _ = x.shape
    q, k, v = jnp.split(x @ w_qkv, 3, axis=-1)
    q = q.reshape(b, s, DA_HEADS, 2, DA_HEAD_DIM)
    k = k.reshape(b, s, DA_HEADS, 2, DA_HEAD_DIM)
    v = v.reshape(b, s, DA_HEADS, 2 * DA_HEAD_DIM)
    lam_init = 0.8 - 0.6 * math.exp(-0.3 * layer_idx)
    lamf = lam.astype(jnp.float32)
    lam_full = jnp.exp(jnp.sum(lamf[0] * lamf[1])) - jnp.exp(jnp.sum(lamf[2] * lamf[3])) + lam_init
    slopes = jnp.asarray(_alibi_slopes(DA_HEADS))[:, None, None, None]
    pos = jnp.arange(s)
    scale = DA_HEAD_DIM ** -0.5

    def block(args):
        qb, pb = args
        sc = jnp.einsum('bqhmd,bkhmd->bhmqk', qb, k).astype(jnp.float32) * scale
        dist = jnp.abs(pb[:, None] - pos[None, :]).astype(jnp.float32)
        p = jax.nn.softmax(sc - slopes * dist, axis=-1)
        a = p[:, :, 0] - lam_full * p[:, :, 1]
        return jnp.einsum('bhqk,bkhe->bqhe', a.astype(v.dtype), v)

    o = _from_blocks(lax.map(block, (_to_blocks(q), pos.reshape(-1, Q_BLOCK))))
    o = _rms_norm(o, subln_g) * (1.0 - lam_init)
    return o.reshape(b, s, -1) @ w_out


def _neighborhood_attention(x, w_qkv, rpb, w_out):
    b, s, _ = x.shape
    rows = s // GRID_W
    kr = min(NA_MAX_ROWS, rows)
    kc = NA_WIN_COLS
    q, k, v = jnp.split(x @ w_qkv, 3, axis=-1)
    grid = (b, rows, GRID_W, NA_HEADS, NA_HEAD_DIM)
    q, k, v = q.reshape(grid), k.reshape(grid), v.reshape(grid)
    col = np.arange(GRID_W)
    cs = np.clip(col - kc // 2, 0, GRID_W - kc)
    col_mask = jnp.asarray((col[None, :] >= cs[:, None]) & (col[None, :] < cs[:, None] + kc))
    dc = np.clip(col[None, :] - col[:, None], -(kc - 1), kc - 1) + (kc - 1)
    rpb_c = rpb[:, :, dc]
    scale = NA_HEAD_DIM ** -0.5

    def row_block(args):
        qr, r = args
        rs = jnp.clip(r - kr // 2, 0, rows - kr)
        kb = lax.dynamic_slice_in_dim(k, rs, kr, axis=1)
        vb = lax.dynamic_slice_in_dim(v, rs, kr, axis=1)
        sc = jnp.einsum('bqhd,bjkhd->bhqjk', qr, kb).astype(jnp.float32) * scale
        dr = rs + jnp.arange(kr) - r + (NA_MAX_ROWS - 1)
        bias = jnp.transpose(rpb_c[:, dr], (0, 2, 1, 3)).astype(jnp.float32)
        sc = jnp.where(col_mask[:, None, :], sc + bias, -jnp.inf)
        p = jax.nn.softmax(sc.reshape(sc.shape[:3] + (kr * GRID_W,)), axis=-1).reshape(sc.shape)
        return jnp.einsum('bhqjk,bjkhd->bqhd', p.astype(vb.dtype), vb)

    o = lax.map(row_block, (jnp.moveaxis(q, 1, 0), jnp.arange(rows)))
    o = jnp.moveaxis(o, 0, 1).reshape(b, s, NA_HEADS * NA_HEAD_DIM)
    return o @ w_out


def _rope(t, cos, sin):
    half = t.shape[-1] // 2
    t1, t2 = t[..., :half], t[..., half:]
    c, sn = cos[:, None, :], sin[:, None, :]
    return jnp.concatenate([t1 * c - t2 * sn, t1 * sn + t2 * c], axis=-1)


def _mla(x, w_a, g_q, g_kv, w_uq, w_ukv, w_out):
    b, s, _ = x.shape
    cq, ckv, k_rope = jnp.split(x @ w_a, [MLA_Q_RANK, MLA_Q_RANK + MLA_KV_RANK], axis=-1)
    cq = _rms_norm(cq, g_q)
    ckv = _rms_norm(ckv, g_kv)
    q = (cq @ w_uq).reshape(b, s, MLA_HEADS, MLA_NOPE + MLA_ROPE)
    kv = (ckv @ w_ukv).reshape(b, s, MLA_HEADS, MLA_NOPE + MLA_V)
    q_nope, q_rope = q[..., :MLA_NOPE], q[..., MLA_NOPE:]
    k_nope, v = kv[..., :MLA_NOPE], kv[..., MLA_NOPE:]
    inv_freq = 1.0 / (ROPE_THETA ** (jnp.arange(0, MLA_ROPE, 2, dtype=jnp.float32) / MLA_ROPE))
    ang = jnp.arange(s, dtype=jnp.float32)[:, None] * inv_freq[None, :]
    cos, sin = jnp.cos(ang).astype(x.dtype), jnp.sin(ang).astype(x.dtype)
    q = jnp.concatenate([q_nope, _rope(q_rope, cos, sin)], axis=-1)
    k_r = jnp.broadcast_to(_rope(k_rope[:, :, None, :], cos, sin), (b, s, MLA_HEADS, MLA_ROPE))
    k = jnp.concatenate([k_nope, k_r], axis=-1)
    scale = (MLA_NOPE + MLA_ROPE) ** -0.5

    def block(qb):
        sc = jnp.einsum('bqhd,bkhd->bhqk', qb, k).astype(jnp.float32) * scale
        p = jax.nn.softmax(sc, axis=-1)
        return jnp.einsum('bhqk,bkhd->bqhd', p.astype(v.dtype), v)

    o = _from_blocks(lax.map(block, _to_blocks(q)))
    return o.reshape(b, s, MLA_HEADS * MLA_V) @ w_out


def _swiglu(x, w_gu, w_down):
    g, u = jnp.split(x @ w_gu, 2, axis=-1)
    return (jax.nn.silu(g) * u) @ w_down


def setup_inputs(seed: int = 0) -> dict:
    key = jax.random.key(seed)
    keys = iter(jax.random.split(key, 32))

    def nrm(shape, scale):
        return jax.random.normal(next(keys), shape, jnp.float32) * scale

    def gain(shape):
        return 1.0 + nrm(shape, 0.01)

    d = D_MODEL
    n0, n1, n2, n3 = _n_uses(0), _n_uses(1), _n_uses(2), _n_uses(3)
    beta = DEEPNORM_BETA
    return {
        "x": nrm((BATCH, SEQ, d), 1.0),
        "conv_w_in": nrm((n0, d, 3 * d), d ** -0.5),
        "conv_w": nrm((n0, CONV_WIDTH, d), CONV_WIDTH ** -0.5),
        "conv_w_out": nrm((n0, d, d), d ** -0.5 * beta),
        "diff_w_qkv": nrm((n1, d, 3 * d), d ** -0.5),
        "diff_lambda": nrm((n1, 4, DA_HEAD_DIM), 0.1),
        "diff_subln_g": gain((n1, 2 * DA_HEAD_DIM)),
        "diff_w_out": nrm((n1, d, d), d ** -0.5 * beta),
        "na_w_qkv": nrm((n2, d, 3 * d), d ** -0.5),
        "na_rpb": nrm((n2, NA_HEADS, 2 * NA_MAX_ROWS - 1, 2 * NA_WIN_COLS - 1), 0.05),
        "na_w_out": nrm((n2, d, d), d ** -0.5 * beta),
        "mla_w_a": nrm((n3, d, MLA_Q_RANK + MLA_KV_RANK + MLA_ROPE), d ** -0.5),
        "mla_g_q": gain((n3, MLA_Q_RANK)),
        "mla_g_kv": gain((n3, MLA_KV_RANK)),
        "mla_w_uq": nrm((n3, MLA_Q_RANK, MLA_HEADS * (MLA_NOPE + MLA_ROPE)), MLA_Q_RANK ** -0.5),
        "mla_w_ukv": nrm((n3, MLA_KV_RANK, MLA_HEADS * (MLA_NOPE + MLA_V)), MLA_KV_RANK ** -0.5),
        "mla_w_out": nrm((n3, MLA_HEADS * MLA_V, d), (MLA_HEADS * MLA_V) ** -0.5 * beta),
        "ln1_g": gain((DEPTH, d)),
        "ln1_b": nrm((DEPTH, d), 0.01),
        "ffn_w_gu": nrm((DEPTH, d, 2 * D_FF), d ** -0.5),
        "ffn_w_down": nrm((DEPTH, D_FF, d), D_FF ** -0.5 * beta),
        "ln2_g": gain((DEPTH, d)),
        "ln2_b": nrm((DEPTH, d), 0.01),
    }


def reference(x, conv_w_in, conv_w, conv_w_out, diff_w_qkv, diff_lambda, diff_subln_g, diff_w_out,
              na_w_qkv, na_rpb, na_w_out, mla_w_a, mla_g_q, mla_g_kv, mla_w_uq, mla_w_ukv, mla_w_out,
              ln1_g, ln1_b, ffn_w_gu, ffn_w_down, ln2_g, ln2_b):
    for i in range(DEPTH):
        m, j = i % N_MIXERS, i // N_MIXERS
        if m == 0:
            h = _short_conv(x, conv_w_in[j], conv_w[j], conv_w_out[j])
        elif m == 1:
            h = _diff_attention(x, diff_w_qkv[j], diff_lambda[j], diff_subln_g[j], diff_w_out[j], i)
        elif m == 2:
            h = _neighborhood_attention(x, na_w_qkv[j], na_rpb[j], na_w_out[j])
        else:
            h = _mla(x, mla_w_a[j], mla_g_q[j], mla_g_kv[j], mla_w_uq[j], mla_w_ukv[j], mla_w_out[j])
        x = _layer_norm(DEEPNORM_ALPHA * x + h, ln1_g[i], ln1_b[i])
        x = _layer_norm(DEEPNORM_ALPHA * x + _swiglu(x, ffn_w_gu[i], ffn_w_down[i]), ln2_g[i], ln2_b[i])
    return x
```

```cpp
#include <hip/hip_runtime.h>
#include <hip/hip_cooperative_groups.h>
#include <cstdio>
#include <cstdint>
#include <cmath>
namespace cg = cooperative_groups;

#ifndef ONE_LAUNCH
#define ONE_LAUNCH 0
#endif

#define DI __device__ __forceinline__
#define LAS __attribute__((address_space(3)))
typedef unsigned short bf16_t;
typedef short bf16x8 __attribute__((ext_vector_type(8)));
typedef float f32x4 __attribute__((ext_vector_type(4)));
typedef float f32x2 __attribute__((ext_vector_type(2)));
typedef float f32x16 __attribute__((ext_vector_type(16)));
typedef unsigned u32x4 __attribute__((ext_vector_type(4)));
typedef unsigned u32x2 __attribute__((ext_vector_type(2)));
typedef __bf16 bf16x2_t __attribute__((ext_vector_type(2)));

constexpr int BATCH = 16, SEQ = 2048, DM = 1024, MROWS = BATCH * SEQ, FF = 2816;
constexpr float ALPHA = 1.681792830507429f;
constexpr float LOG2E = 1.4426950408889634f;
constexpr float LAM_INIT = 0.35550906759096926f;
constexpr int NPH = 32;

constexpr size_t MiB = 1u << 20;
constexpr size_t WS_ROPE = 256 * 1024;
constexpr size_t WS_W = 1 * MiB;
constexpr size_t W_CIN = WS_W + 0 * MiB, W_COUT = WS_W + 6 * MiB, W_DQKV = WS_W + 8 * MiB, W_DOUT = WS_W + 14 * MiB;
constexpr size_t W_NQKV = WS_W + 16 * MiB, W_NOUT = WS_W + 22 * MiB, W_MA = WS_W + 24 * MiB, W_MUQ = WS_W + 25 * MiB;
constexpr size_t W_MUKV = WS_W + 26 * MiB, W_MOUT = WS_W + 27 * MiB, W_GU = WS_W + 29 * MiB, W_DN = WS_W + 73 * MiB;
constexpr size_t W_GU_STRIDE = 11 * MiB, W_DN_STRIDE = 5 * MiB + 512 * 1024;
constexpr size_t WS_XB = 97 * MiB;
constexpr size_t WS_OB = 161 * MiB;
constexpr size_t WS_BIG = 225 * MiB;
constexpr size_t WS_U = WS_BIG, WS_BG = WS_BIG + 64 * MiB, WS_A2C = WS_BIG + 128 * MiB;
constexpr size_t WS_HID = WS_BIG;
constexpr size_t WS_QKV = WS_BIG;
constexpr size_t WS_O1S = WS_BIG + 192 * MiB;
constexpr size_t WS_QM = WS_BIG, WS_KVM = WS_BIG + 96 * MiB, WS_A2M = WS_BIG + 224 * MiB, WS_KR = WS_BIG + 248 * MiB;
constexpr size_t WS_END = WS_BIG + 250 * MiB;

constexpr int LDS_BYTES = 147456;

DI unsigned cvtpk(float lo, float hi) { f32x2 v = {lo, hi}; bf16x2_t b = __builtin_convertvector(v, bf16x2_t); return __builtin_bit_cast(unsigned, b); }
DI float bf_lo(unsigned w) { return __builtin_bit_cast(float, w << 16); }
DI float bf_hi(unsigned w) { return __builtin_bit_cast(float, w & 0xffff0000u); }
DI float wave_sum(float v) {
#pragma unroll
    for (int o = 1; o < 64; o <<= 1) v += __shfl_xor(v, o);
    return v;
}

namespace pg8 {
constexpr int BM = 256, BK = 64, HALF = 128, HTB = HALF * BK * 2, STAGE_BYTES = 8 * HTB, NXCD = 8, WGM = 8;
__host__ __device__ __forceinline__ int lds_byte(int r, int c) { const int st = (r >> 4) * 2 + (c >> 5), rr = r & 15, cc = c & 31, ob = rr * 64 + cc * 2; return st * 1024 + (ob ^ (((ob >> 9) & 1) << 5)); }
__host__ __device__ __forceinline__ void stage_rc(int b, int& R, int& C) { const int st = b / 1024, sb = b % 1024, swz = sb ^ (((sb >> 9) & 1) << 5); R = (st >> 1) * 16 + swz / 64; C = (st & 1) * 32 + (swz % 64) / 2; }
__host__ __device__ __forceinline__ int perm32(int rho) { const int n = rho >> 4, i = rho & 15; return 8 * (i >> 2) + 4 * n + (i & 3); }

struct Unit { int pm, pn; };
struct Gemm { const bf16_t* A; const bf16_t* Bt; int lda, ldb, M, N, K; };

struct StaticOrder {
    int nM, nN, nwg, G, c;
    DI void init(int M, int N, int G_, int c_) { nM = M / BM; nN = N / BM; nwg = nM * nN; G = G_; c = c_; }
    DI bool next(int i, Unit& u) const {
        const long L = (long)i * G + c; if (L >= nwg) return false;
        int wgid = (int)L; { const int q = nwg / NXCD, r = nwg % NXCD, xcd = wgid % NXCD, off = wgid / NXCD; wgid = (xcd < r ? xcd * (q + 1) : r * (q + 1) + (xcd - r) * q) + off; }
        const int nig = WGM * nN, gid = wgid / nig, fm = gid * WGM, gsz = (nM - fm) < WGM ? (nM - fm) : WGM;
        u.pm = fm + ((wgid % nig) % gsz); u.pn = (wgid % nig) / gsz; return true;
    }
};

struct Epi {
    int kind;
    bf16_t* O; bf16_t* O2; int ldc; const float* X; float* Y;
    DI void operator()(const f32x4 (&acc)[2][2][4][2], const Unit& u, int wr, int wc, int fr, int fq) const {
        const int row0 = u.pm * BM + wr * 64 + fr;
        if (kind == 0 || (kind == 2 && u.pn >= 8)) {
            bf16_t* base = (kind == 0) ? O : O2; const int pn = (kind == 0) ? u.pn : u.pn - 8;
            const int col0 = pn * BM + wc * 32 + 8 * fq;
#pragma unroll
            for (int ai = 0; ai < 2; ++ai)
#pragma unroll
                for (int m = 0; m < 4; ++m) { bf16_t* rowp = base + (size_t)(row0 + ai * HALF + m * 16) * ldc + col0;
#pragma unroll
                    for (int bj = 0; bj < 2; ++bj) { const f32x4 v0 = acc[ai][bj][m][0], v1 = acc[ai][bj][m][1];
                        u32x4 w; w.x = cvtpk(v0[0], v0[1]); w.y = cvtpk(v0[2], v0[3]); w.z = cvtpk(v1[0], v1[1]); w.w = cvtpk(v1[2], v1[3]);
                        *(u32x4*)(rowp + bj * HALF) = w; } }
        } else if (kind == 1 || kind == 2) {
            const int col0 = u.pn * HALF + wc * 32 + 8 * fq;
#pragma unroll
            for (int ai = 0; ai < 2; ++ai)
#pragma unroll
                for (int m = 0; m < 4; ++m) { bf16_t* rowp = O + (size_t)(row0 + ai * HALF + m * 16) * ldc + col0;
                    float h[8];
#pragma unroll
                    for (int n = 0; n < 2; ++n)
#pragma unroll
                        for (int j = 0; j < 4; ++j) { const float g = acc[ai][0][m][n][j], uu = acc[ai][1][m][n][j];
                            float a = g;
                            if (kind == 1) a = g * __builtin_amdgcn_rcpf(1.f + __builtin_amdgcn_exp2f(-g * LOG2E));
                            h[n * 4 + j] = a * uu; }
                    u32x4 w; w.x = cvtpk(h[0], h[1]); w.y = cvtpk(h[2], h[3]); w.z = cvtpk(h[4], h[5]); w.w = cvtpk(h[6], h[7]);
                    *(u32x4*)rowp = w; }
        } else {
            const int col0 = u.pn * BM + wc * 32 + 8 * fq;
#pragma unroll
            for (int ai = 0; ai < 2; ++ai)
#pragma unroll
                for (int m = 0; m < 4; ++m) { const size_t ro = (size_t)(row0 + ai * HALF + m * 16) * ldc + col0;
#pragma unroll
                    for (int bj = 0; bj < 2; ++bj)
#pragma unroll
                        for (int n = 0; n < 2; ++n) { const size_t idx = ro + bj * HALF + 4 * n; f32x4 v = acc[ai][bj][m][n];
                            if (kind == 3) { const f32x4 x = *(const f32x4*)(X + idx); v = x * ALPHA + v; }
                            *(f32x4*)(Y + idx) = v; } }
        }
    }
};

DI void gemm_phase(LAS unsigned char* lds, const Gemm g, const StaticOrder& S, const Epi& E, const int tid) {
    const int wid = __builtin_amdgcn_readfirstlane(tid >> 6), lane = tid & 63, wr = wid >> 2, wc = wid & 3, fr = lane & 15, fq = lane >> 4;
    const int K = g.K, nt = K / BK;
    unsigned voffA[2], voffB[2];
#pragma unroll
    for (int i = 0; i < 2; ++i) { int R, C; stage_rc(tid * 16 + i * 8192, R, C); const int Rb = (R & ~31) + perm32(R & 31);
        voffA[i] = (unsigned)(R * g.lda + C) * 2u; voffB[i] = (unsigned)(Rb * g.ldb + C) * 2u; }
    const size_t kstep = (size_t)(BK * 2);
    const size_t hsA = (size_t)HALF * g.lda * 2, hsB = (size_t)HALF * g.ldb * 2;
    const size_t tsA = 2 * hsA, tsB = 2 * hsB;
    const unsigned ldsw = (unsigned)wid * 1024u;
    const int aoff = lds_byte(wr * 64 + fr, fq * 8), boff = lds_byte(wc * 32 + fr, fq * 8);
#define PG8_SA(b, h) (((b) * 2 + (h)) * HTB)
#define PG8_SB(b, h) ((4 + (b) * 2 + (h)) * HTB)
#define PG8_STAGE(bufoff, gbase, voff) do { _Pragma("unroll") for (int _i = 0; _i < 2; ++_i) \
        __builtin_amdgcn_global_load_lds((const unsigned*)((const char*)(gbase) + (voff)[_i]), (LAS unsigned*)(lds + (bufoff) + ldsw + _i * 8192), 16, 0, 0); } while (0)
#define PG8_LDA(dst, b, h) do { _Pragma("unroll") for (int m = 0; m < 4; ++m) _Pragma("unroll") for (int k = 0; k < 2; ++k) dst[m][k] = *(const LAS bf16x8*)(lds + PG8_SA(b, h) + aoff + m * 2048 + k * 1024); } while (0)
#define PG8_LDB(dst, b, h) do { _Pragma("unroll") for (int n = 0; n < 2; ++n) _Pragma("unroll") for (int k = 0; k < 2; ++k) dst[n][k] = *(const LAS bf16x8*)(lds + PG8_SB(b, h) + boff + n * 2048 + k * 1024); } while (0)
#define PG8_MMA(ai, bj, At, Bt) do { __builtin_amdgcn_s_setprio(1); _Pragma("unroll") for (int m = 0; m < 4; ++m) _Pragma("unroll") for (int n = 0; n < 2; ++n) _Pragma("unroll") for (int k = 0; k < 2; ++k) \
        acc[ai][bj][m][n] = __builtin_amdgcn_mfma_f32_16x16x32_bf16(Bt[n][k], At[m][k], acc[ai][bj][m][n], 0, 0, 0); __builtin_amdgcn_s_setprio(0); } while (0)
#define PG8_WAIT_V(n) asm volatile("s_waitcnt vmcnt(" #n ")" ::: "memory")
#define PG8_WAIT_L(n) asm volatile("s_waitcnt lgkmcnt(" #n ")" ::: "memory")
#define PG8_BAR __builtin_amdgcn_s_barrier()
#define PG8_SCHED __builtin_amdgcn_sched_barrier(0)
    Unit cur, nxt; int ui = 0;
    if (!S.next(0, cur)) return;
    f32x4 acc[2][2][4][2];
#pragma unroll
    for (int a = 0; a < 2; ++a)
#pragma unroll
        for (int b = 0; b < 2; ++b)
#pragma unroll
            for (int m = 0; m < 4; ++m)
#pragma unroll
                for (int n = 0; n < 2; ++n) acc[a][b][m][n] = (f32x4){0.f, 0.f, 0.f, 0.f};
    bf16x8 At[4][2], B0[2][2], B1[2][2];
    const char* cA = (const char*)g.A + (size_t)cur.pm * tsA; const char* cB = (const char*)g.Bt + (size_t)cur.pn * tsB;
    PG8_STAGE(PG8_SB(0, 0), cB, voffB); PG8_STAGE(PG8_SB(0, 1), cB + hsB, voffB); PG8_STAGE(PG8_SA(0, 0), cA, voffA); PG8_STAGE(PG8_SA(0, 1), cA + hsA, voffA);
    if (wr == 1) PG8_BAR;
    PG8_WAIT_V(2); PG8_BAR;
    PG8_STAGE(PG8_SB(1, 0), cB + kstep, voffB); PG8_STAGE(PG8_SA(1, 0), cA + kstep, voffA); PG8_STAGE(PG8_SB(1, 1), cB + hsB + kstep, voffB);
    PG8_WAIT_V(6); PG8_BAR;
    for (;;) {
        const bool has_next = S.next(ui + 1, nxt);
        const char* nA = has_next ? (const char*)g.A + (size_t)nxt.pm * tsA : cA; const char* nB = has_next ? (const char*)g.Bt + (size_t)nxt.pn * tsB : cB;
        for (int t = 0; t < nt; t += 2) {
            const bool last = (t == nt - 2);
            const char* a1 = cA + (size_t)(t + 1) * kstep;
            const char* a2 = last ? nA : cA + (size_t)(t + 2) * kstep; const char* b2 = last ? nB : cB + (size_t)(t + 2) * kstep;
            const char* a3 = a2 + kstep; const char* b3 = b2 + kstep;
            PG8_LDB(B0, 0, 0); PG8_LDB(B1, 0, 1); PG8_SCHED; PG8_LDA(At, 0, 0); PG8_STAGE(PG8_SA(1, 1), a1 + hsA, voffA);
            PG8_WAIT_V(8); PG8_WAIT_L(0); PG8_BAR; PG8_MMA(0, 0, At, B0); PG8_MMA(0, 1, At, B1); PG8_BAR; PG8_SCHED;
            PG8_LDA(At, 0, 1); PG8_STAGE(PG8_SB(0, 0), b2, voffB); PG8_STAGE(PG8_SB(0, 1), b2 + hsB, voffB); PG8_STAGE(PG8_SA(0, 0), a2, voffA);
            PG8_WAIT_V(8); PG8_WAIT_L(0); PG8_BAR; PG8_MMA(1, 0, At, B0); PG8_MMA(1, 1, At, B1); PG8_BAR; PG8_SCHED;
            PG8_LDB(B0, 1, 0); PG8_LDB(B1, 1, 1); PG8_SCHED; PG8_LDA(At, 1, 0); PG8_STAGE(PG8_SA(0, 1), a2 + hsA, voffA);
            PG8_WAIT_V(8); PG8_WAIT_L(0); PG8_BAR; PG8_MMA(0, 0, At, B0); PG8_MMA(0, 1, At, B1); PG8_BAR; PG8_SCHED;
            PG8_LDA(At, 1, 1); PG8_STAGE(PG8_SB(1, 0), b3, voffB); PG8_STAGE(PG8_SB(1, 1), b3 + hsB, voffB); PG8_STAGE(PG8_SA(1, 0), a3, voffA);
            PG8_WAIT_V(8); PG8_WAIT_L(0); PG8_BAR; PG8_MMA(1, 0, At, B0); PG8_MMA(1, 1, At, B1); PG8_BAR; PG8_SCHED;
        }
        if (wr == 0) PG8_BAR;
        E(acc, cur, wr, wc, fr, fq);
        if (!has_next) break;
#pragma unroll
        for (int a = 0; a < 2; ++a)
#pragma unroll
            for (int b = 0; b < 2; ++b)
#pragma unroll
                for (int m = 0; m < 4; ++m)
#pragma unroll
                    for (int n = 0; n < 2; ++n) acc[a][b][m][n] = (f32x4){0.f, 0.f, 0.f, 0.f};
        cur = nxt; cA = nA; cB = nB; ++ui;
        if (wr == 1) PG8_BAR;
    }
    PG8_WAIT_V(0);
    PG8_BAR;
#undef PG8_SA
#undef PG8_SB
#undef PG8_STAGE
#undef PG8_LDA
#undef PG8_LDB
#undef PG8_MMA
#undef PG8_WAIT_V
#undef PG8_WAIT_L
#undef PG8_BAR
#undef PG8_SCHED
}
}

namespace att {
constexpr int VS = 144;
constexpr int RPB_OFF = 98304;
DI float hmax(float v) { auto rr = __builtin_amdgcn_permlane32_swap(__float_as_uint(v), __float_as_uint(v), false, false); return fmaxf(__uint_as_float(rr[0]), __uint_as_float(rr[1])); }
DI float hsum(float v) { auto rr = __builtin_amdgcn_permlane32_swap(__float_as_uint(v), __float_as_uint(v), false, false); return __uint_as_float(rr[0]) + __uint_as_float(rr[1]); }

template <int MODE, int DQK, int DV>
DI void flash_pass(LAS unsigned char* lds, const bf16_t* Kg, int ldk, const bf16_t* Kr, const bf16_t* Vg, int ldv,
                   int t_lo, int t_hi, const bf16x8 (&qf)[DQK / 16], f32x16 (&o)[DV / 32],
                   float slope2, int qpos, int qr, const int tid) {
    constexpr int KS = DQK * 2 + 16, KBYTES = 64 * KS, VBYTES = DV * VS, BUF = KBYTES + VBYTES;
    constexpr int KCH = DQK / 8, NKC = 64 * KCH, KIT = (NKC + 511) / 512;
    constexpr int NVP = 32 * (DV / 8);
    static_assert(NVP <= 512 && 2 * BUF <= RPB_OFF, "attention LDS map");
    const int lane = tid & 63, q = lane & 31, hh = lane >> 5;
    u32x4 kreg[KIT]; u32x4 vr0 = {0, 0, 0, 0}, vr1 = {0, 0, 0, 0};
    const int vjp = tid & 31, vdch = tid >> 5; const bool vact = tid < NVP;
    const int vkey = 2 * vjp, vkk = vkey & 31;
    const int vpos = (vkey & 32) + 16 * (vkk >> 4) + 8 * ((vkk >> 2) & 1) + 4 * ((vkk >> 3) & 1) + (vkk & 3);
    const LAS float* rpbL = (const LAS float*)(lds + RPB_OFF);
#define ATT_LOAD(t) do { _Pragma("unroll") for (int it = 0; it < KIT; ++it) { const int c = tid + it * 512; if (c < NKC) { const int key = c / KCH, part = c - key * KCH; \
            const bf16_t* src = (MODE == 2 && part >= 8) ? Kr + (size_t)((t) * 64 + key) * 32 + (part - 8) * 8 : Kg + (size_t)((t) * 64 + key) * ldk + part * 8; \
            kreg[it] = *(const u32x4*)src; } } \
        if (vact) { const bf16_t* vs = Vg + (size_t)((t) * 64 + vkey) * ldv + vdch * 8; vr0 = *(const u32x4*)vs; vr1 = *(const u32x4*)(vs + ldv); } } while (0)
#define ATT_STORE(bp) do { _Pragma("unroll") for (int it = 0; it < KIT; ++it) { const int c = tid + it * 512; if (c < NKC) { const int key = c / KCH, part = c - key * KCH; \
            *(LAS u32x4*)((bp) + key * KS + part * 16) = kreg[it]; } } \
        if (vact) { _Pragma("unroll") for (int i = 0; i < 8; ++i) { const unsigned w0 = vr0[i >> 1], w1 = vr1[i >> 1]; \
            const unsigned val = (i & 1) ? ((w0 >> 16) | (w1 & 0xffff0000u)) : ((w0 & 0xffffu) | (w1 << 16)); \
            *(LAS unsigned*)((bp) + KBYTES + (vdch * 8 + i) * VS + vpos * 2) = val; } } } while (0)

    float m_run = -1e30f, l_run = 0.f;
#pragma unroll
    for (int db = 0; db < DV / 32; ++db)
#pragma unroll
        for (int r = 0; r < 16; ++r) o[db][r] = 0.f;
    ATT_LOAD(t_lo); ATT_STORE(lds); __syncthreads();
    for (int t = t_lo; t < t_hi; ++t) {
        const int cur = (t - t_lo) & 1;
        LAS unsigned char* bp = lds + cur * BUF;
        if (t + 1 < t_hi) ATT_LOAD(t + 1);
        bool active = true;
        if (MODE == 1) { const int rs = min(max(qr - 4, 0), 24); active = (t >= rs) && (t < rs + 8); }
        if (active) {
            f32x16 s0, s1;
#pragma unroll
            for (int r = 0; r < 16; ++r) { s0[r] = 0.f; s1[r] = 0.f; }
#pragma unroll
            for (int st = 0; st < DQK / 16; ++st) {
                const bf16x8 k0 = *(const LAS bf16x8*)(bp + q * KS + st * 32 + hh * 16);
                const bf16x8 k1 = *(const LAS bf16x8*)(bp + (32 + q) * KS + st * 32 + hh * 16);
                s0 = __builtin_amdgcn_mfma_f32_32x32x16_bf16(k0, qf[st], s0, 0, 0, 0);
                s1 = __builtin_amdgcn_mfma_f32_32x32x16_bf16(k1, qf[st], s1, 0, 0, 0);
            }
            if (MODE == 0) {
                const float dq = (float)(t * 64 + 4 * hh - qpos);
#pragma unroll
                for (int r = 0; r < 16; ++r) { const float c = (float)((r & 3) + 8 * (r >> 2));
                    s0[r] = s0[r] - slope2 * fabsf(dq + c); s1[r] = s1[r] - slope2 * fabsf(dq + 32.f + c); }
            }
            if (MODE == 1) {
                const int qc = qpos, cs = min(max(qc - 8, 0), 48), dr31 = (t - qr + 7) * 31;
#pragma unroll
                for (int r = 0; r < 16; ++r) { const int kc0 = (r & 3) + 8 * (r >> 2) + 4 * hh, kc1 = kc0 + 32;
                    const int i0 = min(max(kc0 - qc + 15, 0), 30), i1 = min(max(kc1 - qc + 15, 0), 30);
                    const float b0 = rpbL[dr31 + i0], b1 = rpbL[dr31 + i1];
                    s0[r] = (kc0 >= cs && kc0 < cs + 16) ? s0[r] + b0 : -1e30f;
                    s1[r] = (kc1 >= cs && kc1 < cs + 16) ? s1[r] + b1 : -1e30f; }
            }
            float mx = fmaxf(s0[0], s1[0]);
#pragma unroll
            for (int r = 1; r < 16; ++r) mx = fmaxf(mx, fmaxf(s0[r], s1[r]));
            mx = hmax(mx);
            const float m_new = fmaxf(m_run, mx);
            const float alpha = __builtin_amdgcn_exp2f(m_run - m_new);
            m_run = m_new;
            float ps = 0.f;
#pragma unroll
            for (int r = 0; r < 16; ++r) { s0[r] = __builtin_amdgcn_exp2f(s0[r] - m_new); s1[r] = __builtin_amdgcn_exp2f(s1[r] - m_new); ps += s0[r] + s1[r]; }
            l_run = l_run * alpha + ps;
#pragma unroll
            for (int db = 0; db < DV / 32; ++db)
#pragma unroll
                for (int r = 0; r < 16; ++r) o[db][r] *= alpha;
#pragma unroll
            for (int s = 0; s < 4; ++s) {
                u32x4 pw;
                if (s == 0) { pw.x = cvtpk(s0[0], s0[1]); pw.y = cvtpk(s0[2], s0[3]); pw.z = cvtpk(s0[4], s0[5]); pw.w = cvtpk(s0[6], s0[7]); }
                else if (s == 1) { pw.x = cvtpk(s0[8], s0[9]); pw.y = cvtpk(s0[10], s0[11]); pw.z = cvtpk(s0[12], s0[13]); pw.w = cvtpk(s0[14], s0[15]); }
                else if (s == 2) { pw.x = cvtpk(s1[0], s1[1]); pw.y = cvtpk(s1[2], s1[3]); pw.z = cvtpk(s1[4], s1[5]); pw.w = cvtpk(s1[6], s1[7]); }
                else { pw.x = cvtpk(s1[8], s1[9]); pw.y = cvtpk(s1[10], s1[11]); pw.z = cvtpk(s1[12], s1[13]); pw.w = cvtpk(s1[14], s1[15]); }
                const bf16x8 pf = __builtin_bit_cast(bf16x8, pw);
                __builtin_amdgcn_sched_barrier(0);
#pragma unroll
                for (int db = 0; db < DV / 32; ++db) {
                    const bf16x8 vf = *(const LAS bf16x8*)(bp + KBYTES + (db * 32 + q) * VS + (s * 16 + hh * 8) * 2);
                    o[db] = __builtin_amdgcn_mfma_f32_32x32x16_bf16(vf, pf, o[db], 0, 0, 0);
                }
            }
        }
        if (t + 1 < t_hi) ATT_STORE(lds + (cur ^ 1) * BUF);
        __syncthreads();
    }
    const float inv = 1.f / hsum(l_run);
#pragma unroll
    for (int db = 0; db < DV / 32; ++db)
#pragma unroll
        for (int r = 0; r < 16; ++r) o[db][r] *= inv;
#undef ATT_LOAD
#undef ATT_STORE
}

template <int DV>
DI void store_o(const f32x16 (&o)[DV / 32], bf16_t* orow, int hh, float rs, const float* gsc) {
#pragma unroll
    for (int db = 0; db < DV / 32; ++db)
#pragma unroll
        for (int rg = 0; rg < 4; ++rg) {
            const int d = db * 32 + 8 * rg + 4 * hh;
            float v[4];
#pragma unroll
            for (int j = 0; j < 4; ++j) { v[j] = o[db][4 * rg + j] * rs; if (gsc) v[j] *= gsc[d + j]; }
            u32x2 w; w.x = cvtpk(v[0], v[1]); w.y = cvtpk(v[2], v[3]);
            *(u32x2*)(orow + d) = w;
        }
}
}

struct Params { const float* in[23]; float* out; unsigned char* ws; int ph_lo, ph_hi; float inv_freq[16]; };

DI int col_map(int mode, int c) {
    if (mode == 1) { if (c < FF) return 256 * (c >> 7) + (c & 127); const int d = c - FF; return 256 * (d >> 7) + 128 + (d & 127); }
    if (mode == 2) { if (c < 1024) return 2048 + c; if (c < 2048) { const int d = c - 1024; return 256 * (d >> 7) + (d & 127); } const int d = c - 2048; return 256 * (d >> 7) + 128 + (d & 127); }
    return c;
}
DI void tr_item(const float* W, int K, int N, bf16_t* WT, int ldk, int koff, int mode, int nscale, float sc, LAS float* scr, int item, int lane) {
    const int nblk = N / 32, kb = item / nblk, nb = item - kb * nblk, k0 = 64 * kb, n0 = 32 * nb;
#pragma unroll 8
    for (int i = 0; i < 32; ++i) { const int kk = 2 * i + (lane >> 5); scr[kk * 33 + (lane & 31)] = W[(size_t)(k0 + kk) * N + n0 + (lane & 31)]; }
    asm volatile("s_waitcnt lgkmcnt(0)" ::: "memory");
    const int c = lane & 7;
#pragma unroll
    for (int j = 0; j < 4; ++j) { const int n = (lane >> 3) + 8 * j; const LAS float* s = scr + (8 * c) * 33 + n;
        const float f = (n0 + n < nscale) ? sc : 1.f;
        u32x4 o; o.x = cvtpk(s[0 * 33] * f, s[1 * 33] * f); o.y = cvtpk(s[2 * 33] * f, s[3 * 33] * f); o.z = cvtpk(s[4 * 33] * f, s[5 * 33] * f); o.w = cvtpk(s[6 * 33] * f, s[7 * 33] * f);
        *(u32x4*)(WT + (size_t)col_map(mode, n0 + n) * ldk + koff + k0 + 8 * c) = o; }
    asm volatile("s_waitcnt lgkmcnt(0)" ::: "memory");
}

struct TrJob { const float* W; int K, N; size_t dst; int ldk, koff, mode, nscale; float sc; };
DI TrJob tr_job(const Params& P, int j) {
    const float s64 = 0.125f * LOG2E, s96 = 0.10206207261596577f * LOG2E;
    TrJob t; t.koff = 0; t.mode = 0; t.nscale = 0; t.sc = 1.f;
    if (j == 0) { t.W = P.in[1]; t.K = 1024; t.N = 3072; t.dst = W_CIN; t.ldk = 1024; t.mode = 2; }
    else if (j == 1) { t.W = P.in[3]; t.K = 1024; t.N = 1024; t.dst = W_COUT; t.ldk = 1024; }
    else if (j == 2) { t.W = P.in[4]; t.K = 1024; t.N = 3072; t.dst = W_DQKV; t.ldk = 1024; t.nscale = 1024; t.sc = s64; }
    else if (j == 3) { t.W = P.in[7]; t.K = 1024; t.N = 1024; t.dst = W_DOUT; t.ldk = 1024; }
    else if (j == 4) { t.W = P.in[8]; t.K = 1024; t.N = 3072; t.dst = W_NQKV; t.ldk = 1024; t.nscale = 1024; t.sc = s64; }
    else if (j == 5) { t.W = P.in[10]; t.K = 1024; t.N = 1024; t.dst = W_NOUT; t.ldk = 1024; }
    else if (j == 6) { t.W = P.in[11]; t.K = 1024; t.N = 416; t.dst = W_MA; t.ldk = 1024; }
    else if (j == 7) { t.W = P.in[14]; t.K = 256; t.N = 1536; t.dst = W_MUQ; t.ldk = 256; t.nscale = 1536; t.sc = s96; }
    else if (j == 8) { t.W = P.in[15]; t.K = 128; t.N = 2048; t.dst = W_MUKV; t.ldk = 256; t.koff = 128; }
    else if (j == 9) { t.W = P.in[16]; t.K = 1024; t.N = 1024; t.dst = W_MOUT; t.ldk = 1024; }
    else if (j < 14) { const int l = j - 10; t.W = P.in[19] + (size_t)l * 1024 * 5632; t.K = 1024; t.N = 5632; t.dst = W_GU + l * W_GU_STRIDE; t.ldk = 1024; t.mode = 1; }
    else { const int l = j - 14; t.W = P.in[20] + (size_t)l * FF * 1024; t.K = FF; t.N = 1024; t.dst = W_DN + l * W_DN_STRIDE; t.ldk = FF; }
    return t;
}

DI void prologue(const Params& P, LAS unsigned char* lds, const int tid) {
    const int lane = tid & 63, wave = tid >> 6;
    const int G = gridDim.x, gw = blockIdx.x * 8 + wave, NGW = G * 8;
    LAS float* scr = (LAS float*)(lds + wave * 16384);
    for (int j = 0; j < 18; ++j) {
        const TrJob t = tr_job(P, j);
        const int nit = (t.K / 64) * (t.N / 32);
        for (int it = gw; it < nit; it += NGW) tr_item(t.W, t.K, t.N, (bf16_t*)(P.ws + t.dst), t.ldk, t.koff, t.mode, t.nscale, t.sc, scr, it, lane);
    }
    const size_t gt = (size_t)blockIdx.x * 512 + tid, NT = (size_t)G * 512;
    { u32x4 z = {0, 0, 0, 0};
      u32x4* p0 = (u32x4*)(P.ws + W_MA + (size_t)416 * 1024 * 2);
      for (size_t i = gt; i < (size_t)96 * 1024 * 2 / 16; i += NT) p0[i] = z;
      for (size_t i = gt; i < (size_t)2048 * 16; i += NT) { const size_t r = i >> 4, c = i & 15; *(u32x4*)(P.ws + W_MUKV + r * 512 + c * 16) = z; } }
    { const f32x4* x4 = (const f32x4*)P.in[0]; u32x4* xb = (u32x4*)(P.ws + WS_XB);
      for (size_t i = gt; i < (size_t)MROWS * DM / 8; i += NT) { const f32x4 a = x4[2 * i], b = x4[2 * i + 1];
          u32x4 w; w.x = cvtpk(a[0], a[1]); w.y = cvtpk(a[2], a[3]); w.z = cvtpk(b[0], b[1]); w.w = cvtpk(b[2], b[3]); xb[i] = w; } }
    { float* ct = (float*)(P.ws + WS_ROPE); float* stb = ct + SEQ * 16;
      for (size_t i = gt; i < (size_t)SEQ * 16; i += NT) { const int pos = (int)(i >> 4), k = (int)(i & 15);
          const float ang = (float)pos * P.inv_freq[k];
          double rev = (double)ang * 0.15915494309189535; rev -= __builtin_rint(rev);
          const float fr = (float)rev;
          ct[i] = __builtin_amdgcn_cosf(fr); stb[i] = __builtin_amdgcn_sinf(fr); } }
}

DI void ln_phase(const float* Y, float* XF, bf16_t* XB, const float* g, const float* b, const int tid) {
    const int lane = tid & 63, wave = tid >> 6;
    const int gw = blockIdx.x * 8 + wave, NGW = gridDim.x * 8;
    f32x4 gv[4], bv[4];
#pragma unroll
    for (int j = 0; j < 4; ++j) { gv[j] = ((const f32x4*)g)[lane + 64 * j]; bv[j] = ((const f32x4*)b)[lane + 64 * j]; }
    for (int m = gw; m < MROWS; m += NGW) {
        const f32x4* yr = (const f32x4*)(Y + (size_t)m * DM) + lane;
        f32x4 v[4]; float s = 0.f;
#pragma unroll
        for (int j = 0; j < 4; ++j) { v[j] = yr[64 * j]; s += (v[j][0] + v[j][1]) + (v[j][2] + v[j][3]); }
        const float mean = wave_sum(s) * (1.f / DM); float s2 = 0.f;
#pragma unroll
        for (int j = 0; j < 4; ++j) { v[j] = v[j] - mean; s2 += (v[j][0] * v[j][0] + v[j][1] * v[j][1]) + (v[j][2] * v[j][2] + v[j][3] * v[j][3]); }
        const float rstd = 1.f / sqrtf(wave_sum(s2) * (1.f / DM) + 1e-5f);
        f32x4* xo = (f32x4*)(XF + (size_t)m * DM) + lane; u32x2* bo = (u32x2*)(XB + (size_t)m * DM) + lane;
#pragma unroll
        for (int j = 0; j < 4; ++j) { const f32x4 y = v[j] * rstd * gv[j] + bv[j]; xo[64 * j] = y;
            u32x2 w; w.x = cvtpk(y[0], y[1]); w.y = cvtpk(y[2], y[3]); bo[64 * j] = w; }
    }
}

DI void conv_phase(const bf16_t* U, const bf16_t* BG, const float* cw, bf16_t* A2, const int tid) {
    const size_t gt = (size_t)blockIdx.x * 512 + tid, NT = (size_t)gridDim.x * 512;
    for (size_t i = gt; i < (size_t)MROWS * 128; i += NT) {
        const int t = (int)(i >> 7), ch = (int)(i & 127), s = t & (SEQ - 1);
        const u32x4 z = {0, 0, 0, 0};
        const u32x4 uc = *(const u32x4*)(U + (size_t)t * DM + ch * 8);
        const u32x4 up = (s > 0) ? *(const u32x4*)(U + (size_t)(t - 1) * DM + ch * 8) : z;
        const u32x4 un = (s < SEQ - 1) ? *(const u32x4*)(U + (size_t)(t + 1) * DM + ch * 8) : z;
        const u32x4 bg = *(const u32x4*)(BG + (size_t)t * DM + ch * 8);
        float r[8];
#pragma unroll
        for (int k = 0; k < 4; ++k) {
            const int c = ch * 8 + 2 * k;
            const float y0 = cw[c] * bf_lo(up[k]) + cw[1024 + c] * bf_lo(uc[k]) + cw[2048 + c] * bf_lo(un[k]);
            const float y1 = cw[c + 1] * bf_hi(up[k]) + cw[1024 + c + 1] * bf_hi(uc[k]) + cw[2048 + c + 1] * bf_hi(un[k]);
            r[2 * k] = bf_lo(bg[k]) * y0; r[2 * k + 1] = bf_hi(bg[k]) * y1;
        }
        u32x4 w; w.x = cvtpk(r[0], r[1]); w.y = cvtpk(r[2], r[3]); w.z = cvtpk(r[4], r[5]); w.w = cvtpk(r[6], r[7]);
        *(u32x4*)(A2 + (size_t)t * DM + ch * 8) = w;
    }
}

DI void mla_prep(const Params& P, const int tid) {
    const int lane = tid & 63, wave = tid >> 6;
    const int gw = blockIdx.x * 8 + wave, NGW = gridDim.x * 8;
    const float* CF = (const float*)(P.ws + WS_OB); bf16_t* A2M = (bf16_t*)(P.ws + WS_A2M); bf16_t* KR = (bf16_t*)(P.ws + WS_KR);
    const float* ct = (const float*)(P.ws + WS_ROPE); const float* stb = ct + SEQ * 16;
    const f32x4 gq = ((const f32x4*)P.in[12])[lane]; const f32x2 gk = ((const f32x2*)P.in[13])[lane];
    for (int m = gw; m < MROWS; m += NGW) {
        const float* row = CF + (size_t)m * 512;
        const f32x4 a = ((const f32x4*)row)[lane]; const f32x2 c = ((const f32x2*)(row + 256))[lane];
        const float kr = row[384 + (lane & 31)];
        const float rq = 1.f / sqrtf(wave_sum(a[0] * a[0] + a[1] * a[1] + a[2] * a[2] + a[3] * a[3]) * (1.f / 256) + 1e-6f);
        const float rk = 1.f / sqrtf(wave_sum(c[0] * c[0] + c[1] * c[1]) * (1.f / 128) + 1e-6f);
        u32x2 w; w.x = cvtpk(a[0] * rq * gq[0], a[1] * rq * gq[1]); w.y = cvtpk(a[2] * rq * gq[2], a[3] * rq * gq[3]);
        ((u32x2*)(A2M + (size_t)m * 384))[lane] = w;
        ((unsigned*)(A2M + (size_t)m * 384 + 256))[lane] = cvtpk(c[0] * rk * gk[0], c[1] * rk * gk[1]);
        const int pos = m & (SEQ - 1), i = lane & 15;
        const float cs = ct[pos * 16 + i], sn = stb[pos * 16 + i];
        const float other = __shfl_xor(kr, 16);
        const float outv = ((lane & 31) < 16) ? (kr * cs - other * sn) : (other * sn + kr * cs);
        const float nb = __shfl_down(outv, 1);
        if (lane < 32 && !(lane & 1)) ((unsigned*)(KR + (size_t)m * 32))[lane >> 1] = cvtpk(outv, nb);
    }
}

DI int vcu_of_block() { const int G = gridDim.x, bx = blockIdx.x; return (G % 8 == 0) ? (bx % 8) * (G / 8) + bx / 8 : bx; }

DI void diff_phase(const Params& P, LAS unsigned char* lds, const int tid) {
    const int lane = tid & 63, q = lane & 31, hh = lane >> 5, wave = tid >> 6;
    const bf16_t* QKV = (const bf16_t*)(P.ws + WS_QKV); bf16_t* OB = (bf16_t*)(P.ws + WS_OB);
    float* scr = (float*)(P.ws + WS_O1S) + ((size_t)blockIdx.x * 512 + tid) * 64;
    const float* lamp = P.in[5];
    const float l01 = wave_sum(lamp[lane] * lamp[64 + lane]), l23 = wave_sum(lamp[128 + lane] * lamp[192 + lane]);
    const float lam = __expf(l01) - __expf(l23) + LAM_INIT;
    const float* sg = P.in[6];
    for (int u = vcu_of_block(); u < BATCH * 8 * 8; u += gridDim.x) {
        const int qb = u & 7, h = (u >> 3) & 7, b = u >> 6;
        const int qpos = qb * 256 + wave * 32 + q; const size_t row = (size_t)b * SEQ + qpos;
        const float slope2 = exp2f(-(float)(h + 1)) * LOG2E;
        const bf16_t* base = QKV + (size_t)b * SEQ * 3072;
        f32x16 o[4];
        {   bf16x8 qf[4];
#pragma unroll
            for (int st = 0; st < 4; ++st) qf[st] = *(const bf16x8*)(QKV + row * 3072 + h * 128 + st * 16 + hh * 8);
            att::flash_pass<0, 64, 128>(lds, base + 1024 + h * 128, 3072, nullptr, base + 2048 + h * 128, 3072, 0, 32, qf, o, slope2, qpos, 0, tid);
#pragma unroll
            for (int db = 0; db < 4; ++db)
#pragma unroll
                for (int r = 0; r < 16; r += 4) *(f32x4*)(scr + db * 16 + r) = (f32x4){o[db][r], o[db][r + 1], o[db][r + 2], o[db][r + 3]};
        }
        {   bf16x8 qf[4];
#pragma unroll
            for (int st = 0; st < 4; ++st) qf[st] = *(const bf16x8*)(QKV + row * 3072 + h * 128 + 64 + st * 16 + hh * 8);
            att::flash_pass<0, 64, 128>(lds, base + 1024 + h * 128 + 64, 3072, nullptr, base + 2048 + h * 128, 3072, 0, 32, qf, o, slope2, qpos, 0, tid);
        }
        float ss = 0.f;
#pragma unroll
        for (int db = 0; db < 4; ++db)
#pragma unroll
            for (int r = 0; r < 16; r += 4) { const f32x4 o1 = *(const f32x4*)(scr + db * 16 + r);
#pragma unroll
                for (int j = 0; j < 4; ++j) { const float v = o1[j] - lam * o[db][r + j]; o[db][r + j] = v; ss += v * v; } }
        ss = att::hsum(ss);
        const float rs = (1.f / sqrtf(ss * (1.f / 128) + 1e-6f)) * (1.f - LAM_INIT);
        att::store_o<128>(o, OB + row * DM + h * 128, hh, rs, sg);
    }
}

DI void na_phase(const Params& P, LAS unsigned char* lds, const int tid) {
    const int lane = tid & 63, q = lane & 31, hh = lane >> 5, wave = tid >> 6;
    const bf16_t* QKV = (const bf16_t*)(P.ws + WS_QKV); bf16_t* OB = (bf16_t*)(P.ws + WS_OB);
    LAS float* rpbL = (LAS float*)(lds + att::RPB_OFF);
    for (int u = vcu_of_block(); u < BATCH * 16 * 8; u += gridDim.x) {
        const int r4 = u & 7, h = (u >> 3) & 15, b = u >> 7;
        const int qr = 4 * r4 + (wave >> 1), qc = (wave & 1) * 32 + q; const size_t row = (size_t)b * SEQ + qr * 64 + qc;
        const int t_lo = min(max(4 * r4 - 4, 0), 24), t_hi = min(max(4 * r4 - 1, 0), 24) + 8;
        if (tid < 465) rpbL[tid] = P.in[9][h * 465 + tid] * LOG2E;
        const bf16_t* base = QKV + (size_t)b * SEQ * 3072;
        bf16x8 qf[4];
#pragma unroll
        for (int st = 0; st < 4; ++st) qf[st] = *(const bf16x8*)(QKV + row * 3072 + h * 64 + st * 16 + hh * 8);
        f32x16 o[2];
        att::flash_pass<1, 64, 64>(lds, base + 1024 + h * 64, 3072, nullptr, base + 2048 + h * 64, 3072, t_lo, t_hi, qf, o, 0.f, qc, qr, tid);
        att::store_o<64>(o, OB + row * DM + h * 64, hh, 1.f, nullptr);
    }
}

DI void mla_phase(const Params& P, LAS unsigned char* lds, const int tid) {
    const int lane = tid & 63, q = lane & 31, hh = lane >> 5, wave = tid >> 6;
    const bf16_t* QM = (const bf16_t*)(P.ws + WS_QM); const bf16_t* KVM = (const bf16_t*)(P.ws + WS_KVM); const bf16_t* KR = (const bf16_t*)(P.ws + WS_KR);
    bf16_t* OB = (bf16_t*)(P.ws + WS_OB);
    const float* ct = (const float*)(P.ws + WS_ROPE); const float* stb = ct + SEQ * 16;
    for (int u = vcu_of_block(); u < BATCH * 16 * 8; u += gridDim.x) {
        const int qb = u & 7, h = (u >> 3) & 15, b = u >> 7;
        const int qpos = qb * 256 + wave * 32 + q; const size_t row = (size_t)b * SEQ + qpos;
        const bf16_t* qrow = QM + row * 1536 + h * 96;
        bf16x8 qf[6];
#pragma unroll
        for (int st = 0; st < 4; ++st) qf[st] = *(const bf16x8*)(qrow + st * 16 + hh * 8);
        {   const u32x4 a = *(const u32x4*)(qrow + 64 + hh * 8), bb = *(const u32x4*)(qrow + 80 + hh * 8);
            const f32x4 c0 = *(const f32x4*)(ct + qpos * 16 + hh * 8), c1 = *(const f32x4*)(ct + qpos * 16 + hh * 8 + 4);
            const f32x4 s0 = *(const f32x4*)(stb + qpos * 16 + hh * 8), s1 = *(const f32x4*)(stb + qpos * 16 + hh * 8 + 4);
            float na[8], nb[8];
#pragma unroll
            for (int j = 0; j < 8; ++j) { const float t1 = (j & 1) ? bf_hi(a[j >> 1]) : bf_lo(a[j >> 1]), t2 = (j & 1) ? bf_hi(bb[j >> 1]) : bf_lo(bb[j >> 1]);
                const float c = (j < 4) ? c0[j & 3] : c1[j & 3], s = (j < 4) ? s0[j & 3] : s1[j & 3];
                na[j] = t1 * c - t2 * s; nb[j] = t1 * s + t2 * c; }
            u32x4 wa, wb;
            wa.x = cvtpk(na[0], na[1]); wa.y = cvtpk(na[2], na[3]); wa.z = cvtpk(na[4], na[5]); wa.w = cvtpk(na[6], na[7]);
            wb.x = cvtpk(nb[0], nb[1]); wb.y = cvtpk(nb[2], nb[3]); wb.z = cvtpk(nb[4], nb[5]); wb.w = cvtpk(nb[6], nb[7]);
            qf[4] = __builtin_bit_cast(bf16x8, wa); qf[5] = __builtin_bit_cast(bf16x8, wb); }
        f32x16 o[2];
        att::flash_pass<2, 96, 64>(lds, KVM + (size_t)b * SEQ * 2048 + h * 128, 2048, KR + (size_t)b * SEQ * 32, KVM + (size_t)b * SEQ * 2048 + h * 128 + 64, 2048, 0, 32, qf, o, 0.f, qpos, 0, tid);
        att::store_o<64>(o, OB + row * DM + h * 64, hh, 1.f, nullptr);
    }
}

DI void run_gemm(LAS unsigned char* lds, const bf16_t* A, int lda, const bf16_t* Bt, int ldb, int N, int K, const pg8::Epi& E, const int tid) {
    pg8::Gemm g{A, Bt, lda, ldb, MROWS, N, K}; pg8::StaticOrder S; S.init(MROWS, N, gridDim.x, blockIdx.x);
    pg8::gemm_phase(lds, g, S, E, tid);
}

__global__ void __launch_bounds__(512, 2) fwd_kernel(Params P) {
    extern __shared__ __attribute__((aligned(16))) unsigned char lds_raw[];
    LAS unsigned char* lds = (LAS unsigned char*)lds_raw;
    for (int ph = P.ph_lo; ph < P.ph_hi; ++ph) {
        int tid = threadIdx.x; asm volatile("" : "+v"(tid));
        unsigned char* ws = P.ws; asm volatile("" : "+s"(ws));
        bf16_t* XB = (bf16_t*)(ws + WS_XB); bf16_t* OB = (bf16_t*)(ws + WS_OB);
        if (ph == 0) prologue(P, lds, tid);
        else {
            const int L = (ph <= 7) ? 0 : (ph <= 14) ? 1 : (ph <= 21) ? 2 : 3;
            const int base = 1 + 7 * L, nmix = (L == 3) ? 6 : 3, r = ph - base;
            if (r >= nmix) {
                const int c = r - nmix;
                if (c == 0) ln_phase(P.out, P.out, XB, P.in[17] + L * DM, P.in[18] + L * DM, tid);
                else if (c == 1) { pg8::Epi E{1, (bf16_t*)(ws + WS_HID), nullptr, FF, nullptr, nullptr};
                    run_gemm(lds, XB, DM, (const bf16_t*)(ws + W_GU + L * W_GU_STRIDE), DM, 2 * FF, DM, E, tid); }
                else if (c == 2) { pg8::Epi E{3, nullptr, nullptr, DM, P.out, P.out};
                    run_gemm(lds, (const bf16_t*)(ws + WS_HID), FF, (const bf16_t*)(ws + W_DN + L * W_DN_STRIDE), FF, DM, FF, E, tid); }
                else ln_phase(P.out, P.out, XB, P.in[21] + L * DM, P.in[22] + L * DM, tid);
            } else if (L == 0) {
                if (r == 0) { pg8::Epi E{2, (bf16_t*)(ws + WS_U), (bf16_t*)(ws + WS_BG), DM, nullptr, nullptr};
                    run_gemm(lds, XB, DM, (const bf16_t*)(ws + W_CIN), DM, 3072, DM, E, tid); }
                else if (r == 1) conv_phase((const bf16_t*)(ws + WS_U), (const bf16_t*)(ws + WS_BG), P.in[2], (bf16_t*)(ws + WS_A2C), tid);
                else { pg8::Epi E{3, nullptr, nullptr, DM, P.in[0], P.out};
                    run_gemm(lds, (const bf16_t*)(ws + WS_A2C), DM, (const bf16_t*)(ws + W_COUT), DM, DM, DM, E, tid); }
            } else if (L == 1 || L == 2) {
                if (r == 0) { pg8::Epi E{0, (bf16_t*)(ws + WS_QKV), nullptr, 3072, nullptr, nullptr};
                    run_gemm(lds, XB, DM, (const bf16_t*)(ws + (L == 1 ? W_DQKV : W_NQKV)), DM, 3072, DM, E, tid); }
                else if (r == 1) { if (L == 1) diff_phase(P, lds, tid); else na_phase(P, lds, tid); }
                else { pg8::Epi E{3, nullptr, nullptr, DM, P.out, P.out};
                    run_gemm(lds, OB, DM, (const bf16_t*)(ws + (L == 1 ? W_DOUT : W_NOUT)), DM, DM, DM, E, tid); }
            } else {
                if (r == 0) { pg8::Epi E{4, nullptr, nullptr, 512, nullptr, (float*)(ws + WS_OB)};
                    run_gemm(lds, XB, DM, (const bf16_t*)(ws + W_MA), DM, 512, DM, E, tid); }
                else if (r == 1) mla_prep(P, tid);
                else if (r == 2) { pg8::Epi E{0, (bf16_t*)(ws + WS_QM), nullptr, 1536, nullptr, nullptr};
                    run_gemm(lds, (const bf16_t*)(ws + WS_A2M), 384, (const bf16_t*)(ws + W_MUQ), 256, 1536, 256, E, tid); }
                else if (r == 3) { pg8::Epi E{0, (bf16_t*)(ws + WS_KVM), nullptr, 2048, nullptr, nullptr};
                    run_gemm(lds, (const bf16_t*)(ws + WS_A2M) + 128, 384, (const bf16_t*)(ws + W_MUKV), 256, 2048, 256, E, tid); }
                else if (r == 4) mla_phase(P, lds, tid);
                else { pg8::Epi E{3, nullptr, nullptr, DM, P.out, P.out};
                    run_gemm(lds, OB, DM, (const bf16_t*)(ws + W_MOUT), DM, DM, DM, E, tid); }
            }
        }
        if (ph + 1 < P.ph_hi && ph != 24) cg::this_grid().sync();
    }
}

extern "C" void kernel_launch(void* const* d_in, const int* in_sizes, int n_in, void* d_out, int out_size, void* d_ws, size_t ws_size, hipStream_t stream) {
    static int grid = 0;
    if (grid == 0) {
        if (n_in != 23 || out_size != MROWS * DM || ws_size < WS_END) { fprintf(stderr, "kernel_launch: unexpected shapes (n_in %d out %d ws %zu)\n", n_in, out_size, ws_size); grid = -1; return; }
        int dev = 0, cus = 0, per_cu = 0;
        hipGetDevice(&dev); hipDeviceGetAttribute(&cus, hipDeviceAttributeMultiprocessorCount, dev);
        if (hipFuncSetAttribute((const void*)fwd_kernel, hipFuncAttributeMaxDynamicSharedMemorySize, LDS_BYTES) != hipSuccess) { fprintf(stderr, "kernel_launch: hipFuncSetAttribute failed\n"); grid = -1; return; }
        hipOccupancyMaxActiveBlocksPerMultiprocessor(&per_cu, (const void*)fwd_kernel, 512, LDS_BYTES);
        (void)hipGetLastError();
        if (per_cu < 1) per_cu = 1;
        grid = cus * 1;
        fprintf(stderr, "kernel_launch: cus %d per_cu %d grid %d\n", cus, per_cu, grid);
    }
    if (grid < 0) return;
    Params p{};
    for (int i = 0; i < 23; ++i) p.in[i] = (const float*)d_in[i];
    p.out = (float*)d_out; p.ws = (unsigned char*)d_ws;
    for (int i = 0; i < 16; ++i) p.inv_freq[i] = 1.0f / powf(10000.0f, (float)(2 * i) / 32.0f);
#if ONE_LAUNCH
    p.ph_lo = 0; p.ph_hi = NPH;
    void* args[] = {&p};
    hipError_t e = hipLaunchCooperativeKernel((const void*)fwd_kernel, dim3(grid), dim3(512), args, LDS_BYTES, stream);
    if (e != hipSuccess) fprintf(stderr, "cooperative launch failed: %s (grid %d)\n", hipGetErrorString(e), grid);
#else
    for (int ph = 0; ph < NPH; ++ph) {
        p.ph_lo = ph; p.ph_hi = ph + 1;
        hipLaunchKernelGGL(fwd_kernel, dim3(grid), dim3(512), LDS_BYTES, stream, p);
    }
#endif
}
```
